# Optimizing an MI355X kernel written in HIP

```python
import math
import jax, jax.numpy as jnp
from jax import lax
import numpy as np

D_MODEL = 1024
BATCH = 16
SEQ = 2048
DEPTH = 1

D_FF = 2816
FOX_HEADS = 8
FOX_HEAD_DIM = 64
FOX_WIDTH = FOX_HEADS * FOX_HEAD_DIM
Q_BLOCK = 128
GLA_HEADS = 4
GLA_DK = 64
GLA_DV = 128
GLA_KEY_WIDTH = GLA_HEADS * GLA_DK
GLA_VAL_WIDTH = GLA_HEADS * GLA_DV
GLA_GATE_RANK = 16
GLA_TAU = 16.0
GLA_CHUNK = 64
NORM_EPS = 1e-6

IN_SPLITS = [FOX_WIDTH, FOX_WIDTH, FOX_WIDTH, FOX_HEADS,
             GLA_KEY_WIDTH, GLA_KEY_WIDTH, GLA_VAL_WIDTH, GLA_GATE_RANK, GLA_VAL_WIDTH,
             D_MODEL, D_MODEL]
D_IN = sum(IN_SPLITS)
IN_OFFSETS = [sum(IN_SPLITS[:i + 1]) for i in range(len(IN_SPLITS) - 1)]

kernel_name = "hybrid_fox_gla_gated_macaron"


def rmsnorm(x, g):
    xf = x.astype(jnp.float32)
    y = xf * lax.rsqrt(jnp.mean(xf * xf, axis=-1, keepdims=True) + NORM_EPS)
    return (y * g.astype(jnp.float32)).astype(x.dtype)


def swiglu(x, w_gate, w_up, w_down):
    return (jax.nn.silu(x @ w_gate) * (x @ w_up)) @ w_down


def forgetting_attention(q, k, v, log_f):
    B, S, H, Dh = q.shape
    c = jnp.cumsum(log_f, axis=1).transpose(0, 2, 1)
    scale = Dh ** -0.5
    qf, kf = q.astype(jnp.float32), k.astype(jnp.float32)
    outs = []
    for i in range(S // Q_BLOCK):
        q0 = i * Q_BLOCK
        kend = q0 + Q_BLOCK
        s = jnp.einsum('bqhd,bkhd->bhqk', qf[:, q0:kend], kf[:, :kend]) * scale
        bias = c[:, :, q0:kend, None] - c[:, :, None, :kend]
        mask = (q0 + jnp.arange(Q_BLOCK))[:, None] >= jnp.arange(kend)[None, :]
        s = jnp.where(mask, s + bias, -jnp.inf)
        p = jax.nn.softmax(s, axis=-1)
        outs.append(jnp.einsum('bhqk,bkhd->bqhd', p.astype(v.dtype), v[:, :kend]))
    return jnp.concatenate(outs, axis=1)


def gla_chunked(q, k, v, log_a):
    B, S, H, Dk = q.shape
    Dv = v.shape[-1]
    N, C = S // GLA_CHUNK, GLA_CHUNK

    def to_chunks(t):
        return t.astype(jnp.float32).reshape(B, N, C, H, t.shape[-1]).transpose(0, 3, 1, 2, 4)

    qc = to_chunks(q) * (Dk ** -0.5)
    kc, vc, gc = to_chunks(k), to_chunks(v), to_chunks(log_a)
    b = jnp.cumsum(gc, axis=3)
    b_last = b[:, :, :, -1:, :]
    q_in = qc * jnp.exp(b)
    k_in = kc * jnp.exp(-b)
    k_st = kc * jnp.exp(b_last - b)
    tril = jnp.tril(jnp.ones((C, C), dtype=bool))
    attn = jnp.where(tril, jnp.einsum('bhncd,bhnsd->bhncs', q_in, k_in), 0.0)
    o_intra = jnp.einsum('bhncs,bhnsv->bhncv', attn, vc)
    kv = jnp.einsum('bhnsd,bhnsv->bhndv', k_st, vc)
    decay = jnp.exp(b_last[:, :, :, 0, :])

    def step(state, inp):
        d, kvn = inp
        return d[..., None] * state + kvn, state

    s0 = jnp.zeros((B, H, Dk, Dv), jnp.float32)
    _, s_prev = lax.scan(step, s0, (jnp.moveaxis(decay, 2, 0), jnp.moveaxis(kv, 2, 0)))
    s_prev = jnp.moveaxis(s_prev, 0, 2)
    o = o_intra + jnp.einsum('bhncd,bhndv->bhncv', q_in, s_prev)
    return o.transpose(0, 2, 3, 1, 4).reshape(B, S, H, Dv).astype(v.dtype)


def hybrid_mixer(u, w_in, b_forget, w_alpha_up, b_alpha, gla_norm_g,
                 w_branch_fox, w_branch_gla, w_out):
    B, S, _ = u.shape
    z = u @ w_in
    (fq, fk, fv, f_logit, gq, gk, gv, a_lr, g_r, gate_fox, gate_gla) = jnp.split(z, IN_OFFSETS, axis=-1)
    log_f = jax.nn.log_sigmoid((f_logit + b_forget).astype(jnp.float32))
    o_fox = forgetting_attention(fq.reshape(B, S, FOX_HEADS, FOX_HEAD_DIM),
                                 fk.reshape(B, S, FOX_HEADS, FOX_HEAD_DIM),
                                 fv.reshape(B, S, FOX_HEADS, FOX_HEAD_DIM), log_f)
    o_fox = o_fox.reshape(B, S, FOX_WIDTH)
    log_a = jax.nn.log_sigmoid((a_lr @ w_alpha_up + b_alpha).astype(jnp.float32)) / GLA_TAU
    o_gla = gla_chunked(gq.reshape(B, S, GLA_HEADS, GLA_DK),
                        gk.reshape(B, S, GLA_HEADS, GLA_DK),
                        gv.reshape(B, S, GLA_HEADS, GLA_DV),
                        log_a.reshape(B, S, GLA_HEADS, GLA_DK))
    o_gla = rmsnorm(o_gla, gla_norm_g.reshape(GLA_HEADS, GLA_DV)).reshape(B, S, GLA_VAL_WIDTH)
    o_gla = o_gla * jax.nn.silu(g_r)
    y = jax.nn.sigmoid(gate_fox) * (o_fox @ w_branch_fox) + jax.nn.sigmoid(gate_gla) * (o_gla @ w_branch_gla)
    return y @ w_out


def setup_inputs(seed: int = 0) -> dict:
    key = jax.random.key(seed)
    ks = jax.random.split(key, 24)
    L = DEPTH

    def w(k, shape, fan_in):
        return jax.random.normal(k, shape, jnp.float32) * fan_in ** -0.5

    def gain(k, n):
        return 1.0 + 0.05 * jax.random.normal(k, (L, n), jnp.float32)

    return {
        "x": jax.random.normal(ks[0], (BATCH, SEQ, D_MODEL), jnp.float32),
        "ffn1_pre_g": gain(ks[1], D_MODEL),
        "ffn1_w_gate": w(ks[2], (L, D_MODEL, D_FF), D_MODEL),
        "ffn1_w_up": w(ks[3], (L, D_MODEL, D_FF), D_MODEL),
        "ffn1_w_down": w(ks[4], (L, D_FF, D_MODEL), D_FF),
        "ffn1_post_g": gain(ks[5], D_MODEL),
        "mix_pre_g": gain(ks[6], D_MODEL),
        "w_in": w(ks[7], (L, D_MODEL, D_IN), D_MODEL),
        "b_forget": 0.1 * jax.random.normal(ks[8], (L, FOX_HEADS), jnp.float32),
        "w_alpha_up": w(ks[9], (L, GLA_GATE_RANK, GLA_KEY_WIDTH), GLA_GATE_RANK),
        "b_alpha": 0.1 * jax.random.normal(ks[10], (L, GLA_KEY_WIDTH), jnp.float32),
        "gla_norm_g": gain(ks[11], GLA_VAL_WIDTH),
        "w_branch_fox": w(ks[12], (L, FOX_WIDTH, D_MODEL), FOX_WIDTH),
        "w_branch_gla": w(ks[13], (L, GLA_VAL_WIDTH, D_MODEL), GLA_VAL_WIDTH),
        "w_out": w(ks[14], (L, D_MODEL, D_MODEL), D_MODEL),
        "mix_post_g": gain(ks[15], D_MODEL),
        "ffn2_pre_g": gain(ks[16], D_MODEL),
        "ffn2_w_gate": w(ks[17], (L, D_MODEL, D_FF), D_MODEL),
        "ffn2_w_up": w(ks[18], (L, D_MODEL, D_FF), D_MODEL),
        "ffn2_w_down": w(ks[19], (L, D_FF, D_MODEL), D_FF),
        "ffn2_post_g": gain(ks[20], D_MODEL),
    }


def reference(x, ffn1_pre_g, ffn1_w_gate, ffn1_w_up, ffn1_w_down, ffn1_post_g,
              mix_pre_g, w_in, b_forget, w_alpha_up, b_alpha, gla_norm_g,
              w_branch_fox, w_branch_gla, w_out, mix_post_g,
              ffn2_pre_g, ffn2_w_gate, ffn2_w_up, ffn2_w_down, ffn2_post_g):
    h = x
    for l in range(DEPTH):
        f1 = swiglu(rmsnorm(h, ffn1_pre_g[l]), ffn1_w_gate[l], ffn1_w_up[l], ffn1_w_down[l])
        h = h + 0.5 * rmsnorm(f1, ffn1_post_g[l])
        m = hybrid_mixer(rmsnorm(h, mix_pre_g[l]), w_in[l], b_forget[l], w_alpha_up[l],
                         b_alpha[l], gla_norm_g[l], w_branch_fox[l], w_branch_gla[l], w_out[l])
        h = h + rmsnorm(m, mix_post_g[l])
        f2 = swiglu(rmsnorm(h, ffn2_pre_g[l]), ffn2_w_gate[l], ffn2_w_up[l], ffn2_w_down[l])
        h = h + 0.5 * rmsnorm(f2, ffn2_post_g[l])
    return h
```

```cpp
#include <hip/hip_runtime.h>
#include <stdint.h>

typedef unsigned short bf16_t;
typedef short bf16x8 __attribute__((ext_vector_type(8)));
typedef float f32x4 __attribute__((ext_vector_type(4)));

constexpr int D_MODEL = 1024, BATCH = 16, SEQ = 2048, M_TOK = BATCH * SEQ;
constexpr int D_FF = 2816, D_IN = 5144;
constexpr float NORM_EPS = 1e-6f;

__device__ __forceinline__ bf16_t f2bf(float f) { unsigned u = __float_as_uint(f); return (bf16_t)((u + 0x7fffu + ((u >> 16) & 1u)) >> 16); }
__device__ __forceinline__ float bf2f(bf16_t h) { return __uint_as_float(((unsigned)h) << 16); }
__device__ __forceinline__ float wave_sum(float v) {
#pragma unroll
    for (int o = 1; o < 64; o <<= 1) v += __shfl_xor(v, o);
    return v;
}
__device__ __forceinline__ float log_sigmoid_f(float x) { return fminf(x, 0.f) - log1pf(expf(-fabsf(x))); }
__device__ __forceinline__ float sigmoid_f(float x) { return 1.f / (1.f + expf(-x)); }

__global__ __launch_bounds__(256) void rmsnorm_k(const float* __restrict__ x, const float* __restrict__ g, bf16_t* __restrict__ out) {
    const int row = blockIdx.x * 4 + (threadIdx.x >> 6), lane = threadIdx.x & 63;
    const float4* xr = (const float4*)(x + (size_t)row * D_MODEL);
    float4 v[4]; float s = 0.f;
#pragma unroll
    for (int j = 0; j < 4; ++j) { v[j] = xr[lane + 64 * j]; s += v[j].x * v[j].x + v[j].y * v[j].y + v[j].z * v[j].z + v[j].w * v[j].w; }
    const float rstd = rsqrtf(wave_sum(s) * (1.f / D_MODEL) + NORM_EPS);
#pragma unroll
    for (int j = 0; j < 4; ++j) {
        const float4 gg = ((const float4*)g)[lane + 64 * j];
        ushort4 o; o.x = f2bf(v[j].x * rstd * gg.x); o.y = f2bf(v[j].y * rstd * gg.y); o.z = f2bf(v[j].z * rstd * gg.z); o.w = f2bf(v[j].w * rstd * gg.w);
        ((ushort4*)(out + (size_t)row * D_MODEL))[lane + 64 * j] = o;
    }
}
__global__ __launch_bounds__(256) void postnorm_k(const float* __restrict__ f, const float* __restrict__ gpost, const float* hin, float* hout,
                                                  const float* __restrict__ gnext, bf16_t* __restrict__ xn, float scale, int pad_) {
    const int row = blockIdx.x * 4 + (threadIdx.x >> 6), lane = threadIdx.x & 63;
    const float4* fr = (const float4*)(f + (size_t)row * D_MODEL);
    const float4* hr = (const float4*)(hin + (size_t)row * D_MODEL);
    float4 v[4]; float s = 0.f;
#pragma unroll
    for (int j = 0; j < 4; ++j) { v[j] = fr[lane + 64 * j]; s += v[j].x * v[j].x + v[j].y * v[j].y + v[j].z * v[j].z + v[j].w * v[j].w; }
    const float rstd = rsqrtf(wave_sum(s) * (1.f / D_MODEL) + NORM_EPS);
    float s2 = 0.f;
#pragma unroll
    for (int j = 0; j < 4; ++j) {
        const float4 gg = ((const float4*)gpost)[lane + 64 * j]; const float4 h = hr[lane + 64 * j];
        v[j].x = h.x + scale * v[j].x * rstd * gg.x; v[j].y = h.y + scale * v[j].y * rstd * gg.y; v[j].z = h.z + scale * v[j].z * rstd * gg.z; v[j].w = h.w + scale * v[j].w * rstd * gg.w;
        s2 += v[j].x * v[j].x + v[j].y * v[j].y + v[j].z * v[j].z + v[j].w * v[j].w;
        ((float4*)(hout + (size_t)row * D_MODEL))[lane + 64 * j] = v[j];
    }
    if (gnext) {
        const float r2 = rsqrtf(wave_sum(s2) * (1.f / D_MODEL) + NORM_EPS);
#pragma unroll
        for (int j = 0; j < 4; ++j) {
            const float4 gg = ((const float4*)gnext)[lane + 64 * j];
            ushort4 o; o.x = f2bf(v[j].x * r2 * gg.x); o.y = f2bf(v[j].y * r2 * gg.y); o.z = f2bf(v[j].z * r2 * gg.z); o.w = f2bf(v[j].w * r2 * gg.w);
            ((ushort4*)(xn + (size_t)row * D_MODEL))[lane + 64 * j] = o;
        }
    }
}

struct EpiSwiglu { bf16_t* H; int ld, pad; __device__ void operator()(int r, int c, float g, float u) const { H[(size_t)r * ld + c] = f2bf(g / (1.f + expf(-g)) * u); } };
struct EpiF32 { float* O; int ld, pad; __device__ void operator()(int r, int c, float v, float) const { O[(size_t)r * ld + c] = v; } };
struct EpiBf16 { bf16_t* O; int ld, pad; __device__ void operator()(int r, int c, float v, float) const { O[(size_t)r * ld + c] = f2bf(v); } };
struct EpiLogSig { float* O; const float* bias; int ld, pad; __device__ void operator()(int r, int c, float v, float) const { O[(size_t)r * ld + c] = log_sigmoid_f(v + bias[c]); } };
struct EpiSilu { bf16_t* O; int ld, pad; __device__ void operator()(int r, int c, float v, float) const { O[(size_t)r * ld + c] = f2bf(v / (1.f + expf(-v))); } };
struct EpiSigmoid { bf16_t* O; int ld, pad; __device__ void operator()(int r, int c, float v, float) const { O[(size_t)r * ld + c] = f2bf(sigmoid_f(v)); } };
struct EpiGateSet { float* Y; const bf16_t* G; int ld, pad; __device__ void operator()(int r, int c, float v, float) const { Y[(size_t)r * ld + c] = bf2f(G[(size_t)r * ld + c]) * v; } };
struct EpiGateAdd { const float* Y; bf16_t* O; const bf16_t* G; int ld, pad; __device__ void operator()(int r, int c, float v, float) const { O[(size_t)r * ld + c] = f2bf(Y[(size_t)r * ld + c] + bf2f(G[(size_t)r * ld + c]) * v); } };

template <class Epi, bool DUAL>
__global__ __launch_bounds__(256) void gemm_simple(const bf16_t* __restrict__ A, const float* __restrict__ W, const float* __restrict__ W2, int lda, int ldw, int N, int K, Epi epi) {
    __shared__ __attribute__((aligned(16))) bf16_t As[64][40];
    __shared__ __attribute__((aligned(16))) bf16_t Bs[64][40];
    __shared__ __attribute__((aligned(16))) bf16_t Bs2[DUAL ? 64 : 1][40];
    const int tid = threadIdx.x, lane = tid & 63, wave = tid >> 6, wr = wave >> 1, wc = wave & 1;
    const int m0 = blockIdx.y * 64, n0 = blockIdx.x * 64;
    f32x4 acc[2][2], acc2[2][2];
#pragma unroll
    for (int i = 0; i < 2; ++i)
#pragma unroll
        for (int j = 0; j < 2; ++j) { acc[i][j] = (f32x4){0.f, 0.f, 0.f, 0.f}; acc2[i][j] = (f32x4){0.f, 0.f, 0.f, 0.f}; }
    const int arow = tid >> 2, akc = (tid & 3) * 8;
    const int wk = tid >> 3, wn = (tid & 7) * 8;
    const bool wok = (n0 + wn) < N;
    for (int k0 = 0; k0 < K; k0 += 32) {
        const uint4 av = *(const uint4*)(A + (size_t)(m0 + arow) * lda + k0 + akc);
        float4 w0 = make_float4(0.f, 0.f, 0.f, 0.f), w1 = w0, u0 = w0, u1 = w0;
        if (wok) {
            const float* wp = W + (size_t)(k0 + wk) * ldw + n0 + wn; w0 = *(const float4*)wp; w1 = *(const float4*)(wp + 4);
            if (DUAL) { const float* up = W2 + (size_t)(k0 + wk) * ldw + n0 + wn; u0 = *(const float4*)up; u1 = *(const float4*)(up + 4); }
        }
        __syncthreads();
        *(uint4*)&As[arow][akc] = av;
        Bs[wn + 0][wk] = f2bf(w0.x); Bs[wn + 1][wk] = f2bf(w0.y); Bs[wn + 2][wk] = f2bf(w0.z); Bs[wn + 3][wk] = f2bf(w0.w);
        Bs[wn + 4][wk] = f2bf(w1.x); Bs[wn + 5][wk] = f2bf(w1.y); Bs[wn + 6][wk] = f2bf(w1.z); Bs[wn + 7][wk] = f2bf(w1.w);
        if (DUAL) {
            Bs2[wn + 0][wk] = f2bf(u0.x); Bs2[wn + 1][wk] = f2bf(u0.y); Bs2[wn + 2][wk] = f2bf(u0.z); Bs2[wn + 3][wk] = f2bf(u0.w);
            Bs2[wn + 4][wk] = f2bf(u1.x); Bs2[wn + 5][wk] = f2bf(u1.y); Bs2[wn + 6][wk] = f2bf(u1.z); Bs2[wn + 7][wk] = f2bf(u1.w);
        }
        __syncthreads();
        bf16x8 a[2], b[2], b2[2];
#pragma unroll
        for (int i = 0; i < 2; ++i) a[i] = *(const bf16x8*)&As[wr * 32 + i * 16 + (lane & 15)][8 * (lane >> 4)];
#pragma unroll
        for (int j = 0; j < 2; ++j) { b[j] = *(const bf16x8*)&Bs[wc * 32 + j * 16 + (lane & 15)][8 * (lane >> 4)]; if (DUAL) b2[j] = *(const bf16x8*)&Bs2[wc * 32 + j * 16 + (lane & 15)][8 * (lane >> 4)]; }
#pragma unroll
        for (int i = 0; i < 2; ++i)
#pragma unroll
            for (int j = 0; j < 2; ++j) {
                acc[i][j] = __builtin_amdgcn_mfma_f32_16x16x32_bf16(a[i], b[j], acc[i][j], 0, 0, 0);
                if (DUAL) acc2[i][j] = __builtin_amdgcn_mfma_f32_16x16x32_bf16(a[i], b2[j], acc2[i][j], 0, 0, 0);
            }
    }
#pragma unroll
    for (int i = 0; i < 2; ++i)
#pragma unroll
        for (int j = 0; j < 2; ++j)
#pragma unroll
            for (int r = 0; r < 4; ++r) {
                const int row = m0 + wr * 32 + i * 16 + (lane >> 4) * 4 + r, col = n0 + wc * 32 + j * 16 + (lane & 15);
                if (col < N) epi(row, col, acc[i][j][r], acc2[i][j][r]);
            }
}

__global__ __launch_bounds__(64) void cumsum_k(const float* __restrict__ logf, float* __restrict__ cc) {
    const int bh = blockIdx.x, b = bh >> 3, h = bh & 7, lane = threadIdx.x;
    float v[32]; float run = 0.f;
#pragma unroll
    for (int i = 0; i < 32; ++i) { run += logf[((size_t)b * SEQ + lane * 32 + i) * 8 + h]; v[i] = run; }
    float tot = run, incl = tot;
#pragma unroll
    for (int o = 1; o < 64; o <<= 1) { const float t = __shfl_up(incl, o); if (lane >= o) incl += t; }
    const float excl = incl - tot;
#pragma unroll
    for (int i = 0; i < 32; ++i) cc[(size_t)bh * SEQ + lane * 32 + i] = v[i] + excl;
}
__global__ __launch_bounds__(256) void loga_k(const float* __restrict__ alr, const float* __restrict__ wau, const float* __restrict__ balpha, float* __restrict__ loga) {
    const size_t idx = (size_t)blockIdx.x * 256 + threadIdx.x; const int c = (int)(idx & 255); const size_t m = idx >> 8;
    float s = balpha[c];
#pragma unroll
    for (int r = 0; r < 16; ++r) s += alr[m * 16 + r] * wau[r * 256 + c];
    loga[idx] = log_sigmoid_f(s) * (1.f / 16.f);
}
__global__ __launch_bounds__(64) void fox_attn_k(const bf16_t* __restrict__ qkv, const float* __restrict__ cc, bf16_t* __restrict__ of) {
    __shared__ __attribute__((aligned(16))) bf16_t Ks[64][64];
    __shared__ __attribute__((aligned(16))) bf16_t Vs[64][64];
    __shared__ float Ps[64][64];
    __shared__ float cs[64];
    const int qb = blockIdx.x, bh = blockIdx.y, b = bh >> 3, h = bh & 7, lane = threadIdx.x;
    const int t = qb * 64 + lane; const size_t mrow = (size_t)b * SEQ + t;
    float q[64], o[64];
    {
        const uint4* qp = (const uint4*)(qkv + mrow * 1536 + h * 64);
#pragma unroll
        for (int c8 = 0; c8 < 8; ++c8) { const uint4 v = qp[c8]; const unsigned w[4] = {v.x, v.y, v.z, v.w};
#pragma unroll
            for (int e = 0; e < 4; ++e) { q[c8 * 8 + 2 * e] = __uint_as_float(w[e] << 16) * 0.125f; q[c8 * 8 + 2 * e + 1] = __uint_as_float(w[e] & 0xffff0000u) * 0.125f; } }
    }
#pragma unroll
    for (int d = 0; d < 64; ++d) o[d] = 0.f;
    const float ct = cc[(size_t)bh * SEQ + t];
    float mrun = -INFINITY, l = 0.f;
    for (int kt = 0; kt <= qb; ++kt) {
        __syncthreads();
#pragma unroll
        for (int j = 0; j < 8; ++j) { const int idx = j * 64 + lane, r = idx >> 3, ch = idx & 7; const size_t km = (size_t)b * SEQ + kt * 64 + r;
            *(uint4*)&Ks[r][ch * 8] = *(const uint4*)(qkv + km * 1536 + 512 + h * 64 + ch * 8);
            *(uint4*)&Vs[r][ch * 8] = *(const uint4*)(qkv + km * 1536 + 1024 + h * 64 + ch * 8); }
        cs[lane] = cc[(size_t)bh * SEQ + kt * 64 + lane];
        __syncthreads();
        float mx = -INFINITY;
        for (int j = 0; j < 64; ++j) {
            float sc = 0.f;
#pragma unroll
            for (int c8 = 0; c8 < 8; ++c8) { const uint4 v = *(const uint4*)&Ks[j][c8 * 8]; const unsigned w[4] = {v.x, v.y, v.z, v.w};
#pragma unroll
                for (int e = 0; e < 4; ++e) { sc += q[c8 * 8 + 2 * e] * __uint_as_float(w[e] << 16); sc += q[c8 * 8 + 2 * e + 1] * __uint_as_float(w[e] & 0xffff0000u); } }
            sc += ct - cs[j];
            if (kt * 64 + j > t) sc = -INFINITY;
            Ps[j][lane] = sc; mx = fmaxf(mx, sc);
        }
        const float mnew = fmaxf(mrun, mx), alpha = expf(mrun - mnew);
        l *= alpha;
#pragma unroll
        for (int d = 0; d < 64; ++d) o[d] *= alpha;
        mrun = mnew;
        for (int j = 0; j < 64; ++j) {
            const float p = expf(Ps[j][lane] - mnew); l += p;
#pragma unroll
            for (int c8 = 0; c8 < 8; ++c8) { const uint4 v = *(const uint4*)&Vs[j][c8 * 8]; const unsigned w[4] = {v.x, v.y, v.z, v.w};
#pragma unroll
                for (int e = 0; e < 4; ++e) { o[c8 * 8 + 2 * e] += p * __uint_as_float(w[e] << 16); o[c8 * 8 + 2 * e + 1] += p * __uint_as_float(w[e] & 0xffff0000u); } }
        }
    }
    const float rl = 1.f / l;
    bf16_t* op = of + mrow * 512 + h * 64;
#pragma unroll
    for (int c8 = 0; c8 < 8; ++c8) { uint4 v; unsigned w[4];
#pragma unroll
        for (int e = 0; e < 4; ++e) w[e] = (unsigned)f2bf(o[c8 * 8 + 2 * e] * rl) | ((unsigned)f2bf(o[c8 * 8 + 2 * e + 1] * rl) << 16);
        v.x = w[0]; v.y = w[1]; v.z = w[2]; v.w = w[3]; ((uint4*)op)[c8] = v; }
}

__global__ __launch_bounds__(128) void gla_rec_k(const bf16_t* __restrict__ gqk, const bf16_t* __restrict__ gv, const float* __restrict__ loga, float* __restrict__ og) {
    __shared__ float qs[32][64], ks[32][64], as[32][64];
    const int bh = blockIdx.x, b = bh >> 2, h = bh & 3, dv = threadIdx.x;
    float S[64];
#pragma unroll
    for (int i = 0; i < 64; ++i) S[i] = 0.f;
    for (int t0 = 0; t0 < SEQ; t0 += 32) {
        __syncthreads();
        for (int e = threadIdx.x; e < 32 * 64; e += 128) { const int tt = e >> 6, d = e & 63; const size_t m = (size_t)b * SEQ + t0 + tt;
            qs[tt][d] = bf2f(gqk[m * 512 + h * 64 + d]) * 0.125f; ks[tt][d] = bf2f(gqk[m * 512 + 256 + h * 64 + d]); as[tt][d] = expf(loga[m * 256 + h * 64 + d]); }
        __syncthreads();
        for (int tt = 0; tt < 32; ++tt) {
            const size_t m = (size_t)b * SEQ + t0 + tt;
            const float v = bf2f(gv[m * 512 + h * 128 + dv]);
            float o = 0.f;
#pragma unroll
            for (int i = 0; i < 64; ++i) { S[i] = as[tt][i] * S[i] + ks[tt][i] * v; o += qs[tt][i] * S[i]; }
            og[m * 512 + h * 128 + dv] = o;
        }
    }
}
__global__ __launch_bounds__(256) void gla_norm_k(const float* __restrict__ og, const float* __restrict__ g, const bf16_t* __restrict__ gr, bf16_t* __restrict__ ogn) {
    const size_t mh = (size_t)blockIdx.x * 4 + (threadIdx.x >> 6); const int lane = threadIdx.x & 63; const int h = (int)(mh & 3);
    const size_t base = mh * 128 + lane * 2;
    const float2 v = *(const float2*)(og + base);
    const float rstd = rsqrtf(wave_sum(v.x * v.x + v.y * v.y) * (1.f / 128.f) + NORM_EPS);
    const float2 gg = *(const float2*)(g + h * 128 + lane * 2);
    const unsigned grv = *(const unsigned*)(gr + base);
    const float o0 = v.x * rstd * gg.x * __uint_as_float(grv << 16), o1 = v.y * rstd * gg.y * __uint_as_float(grv & 0xffff0000u);
    *(unsigned*)(ogn + base) = (unsigned)f2bf(o0) | ((unsigned)f2bf(o1) << 16);
}

template <class Epi, bool DUAL>
static void run_gemm(hipStream_t st, const bf16_t* A, int lda, const float* W, const float* W2, int ldw, int N, int K, Epi epi) {
    dim3 grid((N + 63) / 64, M_TOK / 64);
    hipLaunchKernelGGL((gemm_simple<Epi, DUAL>), grid, dim3(256), 0, st, A, W, W2, lda, ldw, N, K, epi);
}

extern "C" void kernel_launch(void* const* d_in, const int* in_sizes, int n_in, void* d_out, int out_size, void* d_ws, size_t ws_size, hipStream_t stream) {
    const float* x = (const float*)d_in[0];
    const float *g1pre = (const float*)d_in[1], *w1g = (const float*)d_in[2], *w1u = (const float*)d_in[3], *w1d = (const float*)d_in[4], *g1post = (const float*)d_in[5];
    const float *gmpre = (const float*)d_in[6], *w_in = (const float*)d_in[7], *b_forget = (const float*)d_in[8], *wau = (const float*)d_in[9], *b_alpha = (const float*)d_in[10];
    const float *gla_g = (const float*)d_in[11], *wbf = (const float*)d_in[12], *wbg = (const float*)d_in[13], *w_out = (const float*)d_in[14], *gmpost = (const float*)d_in[15];
    const float *g2pre = (const float*)d_in[16], *w2g = (const float*)d_in[17], *w2u = (const float*)d_in[18], *w2d = (const float*)d_in[19], *g2post = (const float*)d_in[20];
    float* h = (float*)d_out;
    unsigned char* ws = (unsigned char*)d_ws;
    const size_t MiB = 1u << 20;
    bf16_t* XN = (bf16_t*)(ws + 0);
    float* F = (float*)(ws + 64 * MiB);
    bf16_t* H = (bf16_t*)(ws + 192 * MiB);
    bf16_t* QKV = (bf16_t*)(ws + 192 * MiB);
    bf16_t* GQK = (bf16_t*)(ws + 288 * MiB);
    bf16_t* GV = (bf16_t*)(ws + 320 * MiB);
    bf16_t* GR = (bf16_t*)(ws + 352 * MiB);
    bf16_t* SGF = (bf16_t*)(ws + 384 * MiB);
    bf16_t* SGG = (bf16_t*)(ws + 448 * MiB);
    float* LOGA = (float*)(ws + 64 * MiB);
    bf16_t* OF = (bf16_t*)(ws + 96 * MiB);
    bf16_t* OGN = (bf16_t*)(ws + 128 * MiB);
    float* LOGF = (float*)(ws + 160 * MiB);
    float* ALR = (float*)(ws + 161 * MiB);
    float* CC = (float*)(ws + 163 * MiB);
    float* OGRAW = (float*)(ws + 0);
    float* YF = (float*)(ws + 192 * MiB);
    bf16_t* YB = (bf16_t*)(ws + 320 * MiB);

    hipLaunchKernelGGL(rmsnorm_k, dim3(M_TOK / 4), dim3(256), 0, stream, x, g1pre, XN);
    run_gemm<EpiSwiglu, true>(stream, XN, D_MODEL, w1g, w1u, D_FF, D_FF, D_MODEL, EpiSwiglu{H, D_FF});
    run_gemm<EpiF32, false>(stream, H, D_FF, w1d, nullptr, D_MODEL, D_MODEL, D_FF, EpiF32{F, D_MODEL});
    hipLaunchKernelGGL(postnorm_k, dim3(M_TOK / 4), dim3(256), 0, stream, F, g1post, x, h, gmpre, XN, 0.5f, 0);
    run_gemm<EpiBf16, false>(stream, XN, D_MODEL, w_in + 0, nullptr, D_IN, 1536, D_MODEL, EpiBf16{QKV, 1536});
    run_gemm<EpiLogSig, false>(stream, XN, D_MODEL, w_in + 1536, nullptr, D_IN, 8, D_MODEL, EpiLogSig{LOGF, b_forget, 8, 0});
    run_gemm<EpiBf16, false>(stream, XN, D_MODEL, w_in + 1544, nullptr, D_IN, 512, D_MODEL, EpiBf16{GQK, 512});
    run_gemm<EpiBf16, false>(stream, XN, D_MODEL, w_in + 2056, nullptr, D_IN, 512, D_MODEL, EpiBf16{GV, 512});
    run_gemm<EpiF32, false>(stream, XN, D_MODEL, w_in + 2568, nullptr, D_IN, 16, D_MODEL, EpiF32{ALR, 16});
    run_gemm<EpiSilu, false>(stream, XN, D_MODEL, w_in + 2584, nullptr, D_IN, 512, D_MODEL, EpiSilu{GR, 512});
    run_gemm<EpiSigmoid, false>(stream, XN, D_MODEL, w_in + 3096, nullptr, D_IN, 1024, D_MODEL, EpiSigmoid{SGF, 1024});
    run_gemm<EpiSigmoid, false>(stream, XN, D_MODEL, w_in + 4120, nullptr, D_IN, 1024, D_MODEL, EpiSigmoid{SGG, 1024});
    hipLaunchKernelGGL(cumsum_k, dim3(BATCH * 8), dim3(64), 0, stream, LOGF, CC);
    hipLaunchKernelGGL(fox_attn_k, dim3(SEQ / 64, BATCH * 8), dim3(64), 0, stream, QKV, CC, OF);
    hipLaunchKernelGGL(loga_k, dim3(M_TOK), dim3(256), 0, stream, ALR, wau, b_alpha, LOGA);
    hipLaunchKernelGGL(gla_rec_k, dim3(BATCH * 4), dim3(128), 0, stream, GQK, GV, LOGA, OGRAW);
    hipLaunchKernelGGL(gla_norm_k, dim3(M_TOK), dim3(256), 0, stream, OGRAW, gla_g, GR, OGN);
    run_gemm<EpiGateSet, false>(stream, OF, 512, wbf, nullptr, D_MODEL, D_MODEL, 512, EpiGateSet{YF, SGF, D_MODEL});
    run_gemm<EpiGateAdd, false>(stream, OGN, 512, wbg, nullptr, D_MODEL, D_MODEL, 512, EpiGateAdd{YF, YB, SGG, D_MODEL});
    run_gemm<EpiF32, false>(stream, YB, D_MODEL, w_out, nullptr, D_MODEL, D_MODEL, D_MODEL, EpiF32{F, D_MODEL});
    hipLaunchKernelGGL(postnorm_k, dim3(M_TOK / 4), dim3(256), 0, stream, F, gmpost, (const float*)h, h, g2pre, XN, 1.0f, 0);
    run_gemm<EpiSwiglu, true>(stream, XN, D_MODEL, w2g, w2u, D_FF, D_FF, D_MODEL, EpiSwiglu{H, D_FF});
    run_gemm<EpiF32, false>(stream, H, D_FF, w2d, nullptr, D_MODEL, D_MODEL, D_FF, EpiF32{F, D_MODEL});
    hipLaunchKernelGGL(postnorm_k, dim3(M_TOK / 4), dim3(256), 0, stream, F, g2post, (const float*)h, h, (const float*)nullptr, (bf16_t*)nullptr, 0.5f, 0);
}
```
